# Optimizing an MI355X kernel written in HIP

```python
import math
import jax, jax.numpy as jnp
from jax import lax
import numpy as np

D_MODEL = 1024
BATCH = 2
SEQ = 8192
DEPTH = 2

N_A_LAYERS = DEPTH // 2
N_B_LAYERS = DEPTH - N_A_LAYERS

CONV_WIDTH = D_MODEL
CONV_K = 3

HEAD_DIM = 64
N_Q_HEADS = D_MODEL // HEAD_DIM
N_KV_HEADS = max(1, N_Q_HEADS // 8)
GROUP = N_Q_HEADS // N_KV_HEADS
ATTN_WIDTH = N_Q_HEADS * HEAD_DIM
KV_WIDTH = N_KV_HEADS * HEAD_DIM
WINDOW = 128
BLOCK = 128

N_BUCKETS = 32
MAX_DISTANCE = 128

EPS = 1e-6
NEG_INF = -1e30

kernel_name = "yoco_shortconv_swa_sink_hybrid"


def rmsnorm(x, g):
    xf = x.astype(jnp.float32)
    y = xf * lax.rsqrt(jnp.mean(xf * xf, axis=-1, keepdims=True) + EPS) * g.astype(jnp.float32)
    return y.astype(x.dtype)


def t5_causal_bucket(dist):
    max_exact = N_BUCKETS // 2
    is_small = dist < max_exact
    d = jnp.maximum(dist, 1).astype(jnp.float32)
    large = max_exact + (jnp.log(d / max_exact) / math.log(MAX_DISTANCE / max_exact)
                         * (N_BUCKETS - max_exact)).astype(jnp.int32)
    large = jnp.minimum(large, N_BUCKETS - 1)
    return jnp.where(is_small, dist, large)


def short_conv_mixer(h, w_in, conv_w, w_out):
    proj = h @ w_in
    b_gate, c_gate, u, z = jnp.split(proj, 4, axis=-1)
    v = c_gate * u
    conv = lax.conv_general_dilated(
        v, conv_w[:, None, :].astype(v.dtype),
        window_strides=(1,), padding=[(CONV_K - 1, 0)],
        dimension_numbers=("NWC", "WIO", "NWC"),
        feature_group_count=CONV_WIDTH)
    y = b_gate * conv * jax.nn.silu(z)
    return y @ w_out


def shared_kv(h, kv_norm, w_kv):
    bsz, seq, _ = h.shape
    nb = seq // BLOCK
    kv = rmsnorm(h, kv_norm) @ w_kv
    k, v = jnp.split(kv, 2, axis=-1)
    k = k.reshape(bsz, nb, BLOCK, N_KV_HEADS, HEAD_DIM)
    v = v.reshape(bsz, nb, BLOCK, N_KV_HEADS, HEAD_DIM)

    def band(t):
        prev = jnp.concatenate([jnp.zeros_like(t[:, :1]), t[:, :-1]], axis=1)
        return jnp.concatenate([prev, t], axis=2)

    return band(k), band(v)


def banded_bias_and_mask(nb, rel_bias):
    q_loc = jnp.arange(BLOCK, dtype=jnp.int32)[:, None]
    s_loc = jnp.arange(2 * BLOCK, dtype=jnp.int32)[None, :]
    dist = q_loc + BLOCK - s_loc
    in_window = (dist >= 0) & (dist < WINDOW)
    bucket = t5_causal_bucket(jnp.maximum(dist, 0))
    bias = rel_bias.astype(jnp.float32)[bucket]
    bias = jnp.transpose(bias, (2, 0, 1)).reshape(N_KV_HEADS, GROUP, BLOCK, 2 * BLOCK)
    blk = jnp.arange(nb, dtype=jnp.int32)[:, None, None]
    exists = (blk > 0) | (s_loc >= BLOCK)[None]
    mask = in_window[None] & exists
    return bias, mask


def swa_sink_attention(q, keys, vals, sinks, bias, mask):
    bsz, seq, _ = q.shape
    nb = seq // BLOCK
    qb = q.reshape(bsz, nb, BLOCK, N_KV_HEADS, GROUP, HEAD_DIM)
    scores = jnp.einsum("bnqkgd,bnskd->bnkgqs", qb, keys).astype(jnp.float32)
    logits = scores * (HEAD_DIM ** -0.5) + bias[None, None]
    logits = jnp.where(mask[None, :, None, None], logits, NEG_INF)
    sink = sinks.astype(jnp.float32).reshape(1, 1, N_KV_HEADS, GROUP, 1, 1)
    m = jnp.maximum(jnp.max(logits, axis=-1, keepdims=True), sink)
    p = jnp.exp(logits - m)
    p = p / (jnp.sum(p, axis=-1, keepdims=True) + jnp.exp(sink - m))
    out = jnp.einsum("bnkgqs,bnskd->bnqkgd", p.astype(vals.dtype), vals)
    return out.reshape(bsz, seq, ATTN_WIDTH)


def setup_inputs(seed: int = 0) -> dict:
    key = jax.random.key(seed)
    ks = jax.random.split(key, 16)
    f32 = jnp.float32
    nrm = lambda k, shape, s: jax.random.normal(k, shape, f32) * s
    return {
        "x": nrm(ks[0], (BATCH, SEQ, D_MODEL), 1.0),
        "a_pre_norm": 1.0 + nrm(ks[1], (N_A_LAYERS, D_MODEL), 0.05),
        "a_w_in": nrm(ks[2], (N_A_LAYERS, D_MODEL, 4 * CONV_WIDTH), D_MODEL ** -0.5),
        "a_conv_w": nrm(ks[3], (N_A_LAYERS, CONV_K, CONV_WIDTH), CONV_K ** -0.5),
        "a_w_out": nrm(ks[4], (N_A_LAYERS, CONV_WIDTH, D_MODEL), CONV_WIDTH ** -0.5),
        "a_post_norm": 1.0 + nrm(ks[5], (N_A_LAYERS, D_MODEL), 0.05),
        "kv_norm": 1.0 + nrm(ks[6], (D_MODEL,), 0.05),
        "w_kv": nrm(ks[7], (D_MODEL, 2 * KV_WIDTH), D_MODEL ** -0.5),
        "rel_bias": nrm(ks[8], (N_BUCKETS, N_Q_HEADS), 0.1),
        "b_pre_norm": 1.0 + nrm(ks[9], (N_B_LAYERS, D_MODEL), 0.05),
        "b_w_in": nrm(ks[10], (N_B_LAYERS, D_MODEL, 2 * ATTN_WIDTH), D_MODEL ** -0.5),
        "b_sinks": nrm(ks[11], (N_B_LAYERS, N_Q_HEADS), 0.5),
        "b_w_out": nrm(ks[12], (N_B_LAYERS, ATTN_WIDTH, D_MODEL), ATTN_WIDTH ** -0.5),
        "b_post_norm": 1.0 + nrm(ks[13], (N_B_LAYERS, D_MODEL), 0.05),
    }


def reference(x, a_pre_norm, a_w_in, a_conv_w, a_w_out, a_post_norm,
              kv_norm, w_kv, rel_bias,
              b_pre_norm, b_w_in, b_sinks, b_w_out, b_post_norm):
    h = x
    nb = x.shape[1] // BLOCK
    bias, mask = banded_bias_and_mask(nb, rel_bias)
    keys = vals = None
    for layer in range(DEPTH):
        if layer < N_A_LAYERS:
            i = layer
            y = short_conv_mixer(rmsnorm(h, a_pre_norm[i]), a_w_in[i], a_conv_w[i], a_w_out[i])
            h = h + rmsnorm(y, a_post_norm[i])
            if layer == N_A_LAYERS - 1:
                keys, vals = shared_kv(h, kv_norm, w_kv)
        else:
            j = layer - N_A_LAYERS
            qz = rmsnorm(h, b_pre_norm[j]) @ b_w_in[j]
            q, z = jnp.split(qz, 2, axis=-1)
            o = swa_sink_attention(q, keys, vals, b_sinks[j], bias, mask) * jax.nn.silu(z)
            y = o @ b_w_out[j]
            h = h + rmsnorm(y, b_post_norm[j])
    return h
```

```cpp
#include <hip/hip_runtime.h>
#include <cstdio>
#include <cstdint>

namespace nv {
constexpr int D = 1024, BATCH = 2, SEQ = 8192, M = BATCH * SEQ;
constexpr int HD = 64, NQH = 16, NKVH = 2, GROUP = 8, KVW = 128, WINDOW = 128;
constexpr float EPS = 1e-6f;

__device__ const unsigned char BUCKET[128] = {0, 1, 2, 3, 4, 5, 6, 7, 8, 9, 10, 11, 12, 13, 14, 15, 16, 16, 16, 17, 17, 18, 18, 18, 19, 19, 19, 20, 20, 20, 20, 21, 21, 21, 21, 22, 22, 22, 22, 22, 23, 23, 23, 23, 23, 23, 24, 24, 24, 24, 24, 24, 25, 25, 25, 25, 25, 25, 25, 26, 26, 26, 26, 26, 26, 26, 26, 27, 27, 27, 27, 27, 27, 27, 27, 27, 27, 28, 28, 28, 28, 28, 28, 28, 28, 28, 28, 29, 29, 29, 29, 29, 29, 29, 29, 29, 29, 29, 29, 30, 30, 30, 30, 30, 30, 30, 30, 30, 30, 30, 30, 30, 30, 31, 31, 31, 31, 31, 31, 31, 31, 31, 31, 31, 31, 31, 31, 31};

__device__ __forceinline__ float wave_sum(float v) {
#pragma unroll
    for (int o = 1; o < 64; o <<= 1) v += __shfl_xor(v, o);
    return v;
}
__device__ __forceinline__ float wave_max(float v) {
#pragma unroll
    for (int o = 1; o < 64; o <<= 1) v = fmaxf(v, __shfl_xor(v, o));
    return v;
}
__device__ __forceinline__ float silu(float z) { return z / (1.f + __expf(-z)); }

__global__ void __launch_bounds__(256) rmsnorm_k(const float* __restrict__ in, const float* __restrict__ g, const float* res, float* out) {
    const int row = blockIdx.x * 4 + (threadIdx.x >> 6), lane = threadIdx.x & 63;
    const float4* ir = (const float4*)(in + (size_t)row * D);
    float4 v[4]; float s = 0.f;
#pragma unroll
    for (int j = 0; j < 4; ++j) { v[j] = ir[lane + 64 * j]; s += v[j].x * v[j].x + v[j].y * v[j].y + v[j].z * v[j].z + v[j].w * v[j].w; }
    const float rstd = rsqrtf(wave_sum(s) * (1.f / D) + EPS);
    const float4* gr = (const float4*)g;
    float4* orow = (float4*)(out + (size_t)row * D);
#pragma unroll
    for (int j = 0; j < 4; ++j) {
        const float4 gg = gr[lane + 64 * j]; float4 o;
        o.x = v[j].x * rstd * gg.x; o.y = v[j].y * rstd * gg.y; o.z = v[j].z * rstd * gg.z; o.w = v[j].w * rstd * gg.w;
        if (res) { const float4 r = ((const float4*)(res + (size_t)row * D))[lane + 64 * j]; o.x += r.x; o.y += r.y; o.z += r.z; o.w += r.w; }
        orow[lane + 64 * j] = o;
    }
}

__global__ void __launch_bounds__(256) gemm_k(const float* __restrict__ A, const float* __restrict__ B, float* __restrict__ C, int K, int ldb, int ldc, int boff) {
    __shared__ float As[16][65], Bs[16][65];
    const int tx = threadIdx.x & 15, ty = threadIdx.x >> 4;
    const int m0 = blockIdx.y * 64, n0 = blockIdx.x * 64;
    float acc[4][4] = {};
    for (int k0 = 0; k0 < K; k0 += 16) {
        {
            const int r = threadIdx.x >> 2, c4 = (threadIdx.x & 3) * 4;
            const float4 a = *(const float4*)(A + (size_t)(m0 + r) * K + k0 + c4);
            As[c4 + 0][r] = a.x; As[c4 + 1][r] = a.y; As[c4 + 2][r] = a.z; As[c4 + 3][r] = a.w;
            const int kr = threadIdx.x >> 4, c = (threadIdx.x & 15) * 4;
            const float4 b = *(const float4*)(B + (size_t)(k0 + kr) * ldb + boff + n0 + c);
            Bs[kr][c + 0] = b.x; Bs[kr][c + 1] = b.y; Bs[kr][c + 2] = b.z; Bs[kr][c + 3] = b.w;
        }
        __syncthreads();
#pragma unroll
        for (int k = 0; k < 16; ++k) {
            float a[4], b[4];
#pragma unroll
            for (int i = 0; i < 4; ++i) { a[i] = As[k][ty * 4 + i]; b[i] = Bs[k][tx * 4 + i]; }
#pragma unroll
            for (int i = 0; i < 4; ++i)
#pragma unroll
                for (int j = 0; j < 4; ++j) acc[i][j] += a[i] * b[j];
        }
        __syncthreads();
    }
#pragma unroll
    for (int i = 0; i < 4; ++i) *(float4*)(C + (size_t)(m0 + ty * 4 + i) * ldc + n0 + tx * 4) = make_float4(acc[i][0], acc[i][1], acc[i][2], acc[i][3]);
}

__global__ void __launch_bounds__(256) gemm1_gate_k(const float* __restrict__ A, const float* __restrict__ B, float* __restrict__ Vo, float* __restrict__ Go) {
    __shared__ float As[16][65], Bs[4][16][33];
    const int tx = threadIdx.x & 15, ty = threadIdx.x >> 4;
    const int m0 = blockIdx.y * 64, n0 = blockIdx.x * 32;
    float acc[4][4][2] = {};
    for (int k0 = 0; k0 < D; k0 += 16) {
        {
            const int r = threadIdx.x >> 2, c4 = (threadIdx.x & 3) * 4;
            const float4 a = *(const float4*)(A + (size_t)(m0 + r) * D + k0 + c4);
            As[c4 + 0][r] = a.x; As[c4 + 1][r] = a.y; As[c4 + 2][r] = a.z; As[c4 + 3][r] = a.w;
            for (int e = threadIdx.x; e < 2048; e += 256) { const int gt = e >> 9, kr = (e >> 5) & 15, c = e & 31; Bs[gt][kr][c] = B[(size_t)(k0 + kr) * 4096 + gt * 1024 + n0 + c]; }
        }
        __syncthreads();
#pragma unroll
        for (int k = 0; k < 16; ++k) {
            float a[4];
#pragma unroll
            for (int i = 0; i < 4; ++i) a[i] = As[k][ty * 4 + i];
#pragma unroll
            for (int gt = 0; gt < 4; ++gt) {
                const float b0 = Bs[gt][k][tx * 2], b1 = Bs[gt][k][tx * 2 + 1];
#pragma unroll
                for (int i = 0; i < 4; ++i) { acc[gt][i][0] += a[i] * b0; acc[gt][i][1] += a[i] * b1; }
            }
        }
        __syncthreads();
    }
#pragma unroll
    for (int i = 0; i < 4; ++i)
#pragma unroll
        for (int j = 0; j < 2; ++j) {
            const size_t o = (size_t)(m0 + ty * 4 + i) * D + n0 + tx * 2 + j;
            Vo[o] = acc[1][i][j] * acc[2][i][j];
            Go[o] = acc[0][i][j] * silu(acc[3][i][j]);
        }
}

__global__ void __launch_bounds__(256) conv_k(const float* __restrict__ V, const float* __restrict__ G, const float* __restrict__ cw, float* __restrict__ Y) {
    const size_t i = (size_t)blockIdx.x * 256 + threadIdx.x;
    const int c = (int)(i % D); const int row = (int)(i / D); const int t = row % SEQ;
    const float w0 = cw[c], w1 = cw[D + c], w2 = cw[2 * D + c];
    float s = w2 * V[i];
    if (t >= 1) s += w1 * V[i - D];
    if (t >= 2) s += w0 * V[i - 2 * D];
    Y[i] = G[i] * s;
}

__global__ void __launch_bounds__(256) attn_k(const float* __restrict__ Q, const float* __restrict__ KV, const float* __restrict__ Z, const float* __restrict__ sinks,
                                              const float* __restrict__ rel_bias, float* __restrict__ O) {
    __shared__ float ps[4][128];
    const int w = threadIdx.x >> 6, lane = threadIdx.x & 63;
    const int gid = blockIdx.x * 4 + w;
    const int h = gid & 15, row = gid >> 4, t = row % SEQ, kvh = h / GROUP;
    const float* q = Q + (size_t)row * D + h * HD;
    float lg[2];
#pragma unroll
    for (int jj = 0; jj < 2; ++jj) {
        const int dist = lane + 64 * jj;
        float s = -1e30f;
        if (t - dist >= 0) {
            const float* k = KV + (size_t)(row - dist) * 256 + kvh * HD;
            float a = 0.f;
            for (int d = 0; d < HD; ++d) a += q[d] * k[d];
            s = a * 0.125f + rel_bias[BUCKET[dist] * NQH + h];
        }
        lg[jj] = s;
    }
    const float sink = sinks[h];
    const float m = fmaxf(wave_max(fmaxf(lg[0], lg[1])), sink);
    const float p0 = __expf(lg[0] - m), p1 = __expf(lg[1] - m);
    const float den = wave_sum(p0 + p1) + __expf(sink - m);
    ps[w][lane] = p0 / den; ps[w][lane + 64] = p1 / den;
    __syncthreads();
    float o = 0.f;
    const int nk = (t + 1 < WINDOW) ? t + 1 : WINDOW;
    for (int dist = 0; dist < nk; ++dist) o += ps[w][dist] * KV[(size_t)(row - dist) * 256 + 128 + kvh * HD + lane];
    const float z = Z[(size_t)row * D + h * HD + lane];
    O[(size_t)row * D + h * HD + lane] = o * silu(z);
}
}

extern "C" void kernel_launch(void* const* d_in, const int* in_sizes, int n_in, void* d_out, int out_size, void* d_ws, size_t ws_size, hipStream_t stream) {
    using namespace nv;
    const float* x = (const float*)d_in[0];
    const float* a_pre = (const float*)d_in[1]; const float* a_w_in = (const float*)d_in[2]; const float* a_conv = (const float*)d_in[3];
    const float* a_w_out = (const float*)d_in[4]; const float* a_post = (const float*)d_in[5]; const float* kv_norm = (const float*)d_in[6];
    const float* w_kv = (const float*)d_in[7]; const float* rel_bias = (const float*)d_in[8]; const float* b_pre = (const float*)d_in[9];
    const float* b_w_in = (const float*)d_in[10]; const float* b_sinks = (const float*)d_in[11]; const float* b_w_out = (const float*)d_in[12];
    const float* b_post = (const float*)d_in[13];
    float* out = (float*)d_out;
    const size_t MiB = 1u << 20;
    float* B1 = (float*)((char*)d_ws + 0 * MiB); float* B2 = (float*)((char*)d_ws + 64 * MiB); float* B3 = (float*)((char*)d_ws + 128 * MiB);
    float* KVb = (float*)((char*)d_ws + 192 * MiB);
    rmsnorm_k<<<M / 4, 256, 0, stream>>>(x, a_pre, nullptr, B1);
    gemm1_gate_k<<<dim3(D / 32, M / 64), 256, 0, stream>>>(B1, a_w_in, B2, B3);
    conv_k<<<(M * D) / 256, 256, 0, stream>>>(B2, B3, a_conv, B1);
    gemm_k<<<dim3(D / 64, M / 64), 256, 0, stream>>>(B1, a_w_out, B2, D, D, D, 0);
    rmsnorm_k<<<M / 4, 256, 0, stream>>>(B2, a_post, x, out);
    rmsnorm_k<<<M / 4, 256, 0, stream>>>(out, kv_norm, nullptr, B1);
    gemm_k<<<dim3(256 / 64, M / 64), 256, 0, stream>>>(B1, w_kv, KVb, D, 256, 256, 0);
    rmsnorm_k<<<M / 4, 256, 0, stream>>>(out, b_pre, nullptr, B1);
    gemm_k<<<dim3(D / 64, M / 64), 256, 0, stream>>>(B1, b_w_in, B2, D, 2048, D, 0);
    gemm_k<<<dim3(D / 64, M / 64), 256, 0, stream>>>(B1, b_w_in, B3, D, 2048, D, 1024);
    attn_k<<<(M * NQH) / 4, 256, 0, stream>>>(B2, KVb, B3, b_sinks, rel_bias, B1);
    gemm_k<<<dim3(D / 64, M / 64), 256, 0, stream>>>(B1, b_w_out, B2, D, D, D, 0);
    rmsnorm_k<<<M / 4, 256, 0, stream>>>(B2, b_post, out, out);
}
```
